# Optimizing an MI355X kernel written in HIP

```python
import math
import jax, jax.numpy as jnp
from jax import lax
import numpy as np


D_MODEL = 1024
BATCH = 4
SEQ = 4096
DEPTH = 1

PLE_DIM = 256
GDN_HEADS = 4
GDN_DK = 128
GDN_DV = 128
CONV_WIDTH = 4
CHUNK = 64
DIFF_HEADS = 4
DIFF_D = 64
DIFF_DV = 2 * DIFF_D
Q_BLOCK = 128
ROPE_THETA = 500000.0
ROPE_DIM = DIFF_D // 4
N_EXPERTS = 32
TOP_K = 4
D_FF = D_MODEL
SWIGLU_LIMIT = 7.0
SWIGLU_ALPHA = 1.702
MOE_BLOCK = 128
DN_ALPHA = (2 * DEPTH) ** 0.25
DN_BETA = (8 * DEPTH) ** -0.25
LN_EPS = 1e-5
RMS_EPS = 1e-6

GDN_QK_W = GDN_HEADS * GDN_DK
GDN_V_W = GDN_HEADS * GDN_DV
DIFF_QK_W = DIFF_HEADS * 2 * DIFF_D
DIFF_V_W = DIFF_HEADS * DIFF_DV
MIX_W = GDN_V_W + DIFF_V_W
IN_SIZES = (GDN_QK_W, GDN_QK_W, GDN_V_W, GDN_V_W, GDN_HEADS, GDN_HEADS, DIFF_QK_W, DIFF_QK_W, DIFF_V_W)
IN_OFFSETS = tuple(int(o) for o in np.cumsum(IN_SIZES)[:-1])
IN_W = int(sum(IN_SIZES))
CONV_CH = 2 * GDN_QK_W + GDN_V_W

kernel_name = 'hybrid_gdn_diffattn_moe_deepnorm'

F32 = jnp.float32


def layer_norm(x, g, b):
    xf = x.astype(F32)
    mu = jnp.mean(xf, -1, keepdims=True)
    var = jnp.mean(jnp.square(xf - mu), -1, keepdims=True)
    return ((xf - mu) * lax.rsqrt(var + LN_EPS) * g.astype(F32) + b.astype(F32)).astype(x.dtype)


def rms_norm(x, g):
    xf = x.astype(F32)
    return (xf * lax.rsqrt(jnp.mean(xf * xf, -1, keepdims=True) + RMS_EPS) * g.astype(F32)).astype(x.dtype)


def l2_normalize(x):
    xf = x.astype(F32)
    return xf * lax.rsqrt(jnp.sum(xf * xf, -1, keepdims=True) + 1e-6)


def causal_depthwise_conv(x, w):
    c = x.shape[-1]
    return lax.conv_general_dilated(x, w[:, None, :].astype(x.dtype), window_strides=(1,),
                                    padding=[(CONV_WIDTH - 1, 0)],
                                    dimension_numbers=('NWC', 'WIO', 'NWC'),
                                    feature_group_count=c)


def partial_rotary(x, cos, sin):
    xr, xp = x[..., :ROPE_DIM], x[..., ROPE_DIM:]
    x1, x2 = xr[..., :ROPE_DIM // 2], xr[..., ROPE_DIM // 2:]
    rot = jnp.concatenate([-x2, x1], -1)
    return jnp.concatenate([xr * cos + rot * sin, xp], -1)


def gated_delta_rule_chunked(q, k, v, g, beta):
    b_, s_, h_, dk = q.shape
    dv = v.shape[-1]
    n = s_ // CHUNK

    def chunks(t):
        t = jnp.moveaxis(t, 2, 1)
        return t.reshape((b_, h_, n, CHUNK) + t.shape[3:])

    q = chunks(l2_normalize(q) * (dk ** -0.5))
    k = chunks(l2_normalize(k))
    v = chunks(v.astype(F32))
    beta = chunks(beta.astype(F32))
    g = jnp.cumsum(chunks(g.astype(F32)), axis=-1)
    idx = jnp.arange(CHUNK)
    incl = idx[:, None] >= idx[None, :]
    strict = idx[:, None] > idx[None, :]
    decay = jnp.exp(jnp.where(incl, g[..., :, None] - g[..., None, :], -jnp.inf))
    k_beta = k * beta[..., None]
    a_mat = jnp.where(strict, jnp.einsum('bhncd,bhnjd->bhncj', k_beta, k) * decay, 0.0)
    lhs = a_mat + jnp.eye(CHUNK, dtype=F32)
    rhs = jnp.concatenate([v * beta[..., None], k_beta * jnp.exp(g)[..., None]], -1)
    sol = lax.linalg.triangular_solve(lhs, rhs, left_side=True, lower=True, unit_diagonal=True)
    u, w = sol[..., :dv], sol[..., dv:]
    qk = jnp.where(incl, jnp.einsum('bhncd,bhnjd->bhncj', q, k) * decay, 0.0)
    q_dec = q * jnp.exp(g)[..., None]
    k_dec = k * jnp.exp(g[..., -1:] - g)[..., None]
    g_last = jnp.exp(g[..., -1])

    def step(state, xs):
        u_c, w_c, qk_c, qd_c, kd_c, gl_c = xs
        v_new = u_c - jnp.einsum('bhck,bhkv->bhcv', w_c, state)
        o = jnp.einsum('bhck,bhkv->bhcv', qd_c, state) + jnp.einsum('bhcj,bhjv->bhcv', qk_c, v_new)
        state = state * gl_c[..., None, None] + jnp.einsum('bhck,bhcv->bhkv', kd_c, v_new)
        return state, o

    xs = tuple(jnp.moveaxis(t, 2, 0) for t in (u, w, qk, q_dec, k_dec, g_last))
    state0 = jnp.zeros((b_, h_, dk, dv), F32)
    _, o = lax.scan(step, state0, xs)
    o = jnp.moveaxis(o, 0, 2).reshape(b_, h_, s_, dv)
    return jnp.moveaxis(o, 1, 2)


def diff_attention(q, k, v, lam):
    b_, s_, h_, _, d = q.shape
    dv = v.shape[-1]
    nb = s_ // Q_BLOCK
    kh = jnp.transpose(k, (0, 2, 3, 1, 4))
    vh = jnp.transpose(v, (0, 2, 1, 3))
    qb = jnp.transpose(q, (0, 2, 3, 1, 4)).reshape(b_, h_, 2, nb, Q_BLOCK, d)
    qb = jnp.moveaxis(qb, 3, 0)
    kpos = jnp.arange(s_)
    scale = d ** -0.5

    def block(args):
        q_blk, i = args
        sc = jnp.einsum('bhcqd,bhckd->bhcqk', q_blk, kh, preferred_element_type=F32) * scale
        qpos = i * Q_BLOCK + jnp.arange(Q_BLOCK)
        sc = jnp.where(kpos[None, :] <= qpos[:, None], sc, -jnp.inf)
        pr = jax.nn.softmax(sc, axis=-1)
        a = pr[:, :, 0] - lam * pr[:, :, 1]
        return jnp.einsum('bhqk,bhkv->bhqv', a.astype(vh.dtype), vh)

    o = lax.map(block, (qb, jnp.arange(nb)))
    o = jnp.moveaxis(o, 0, 2).reshape(b_, h_, s_, dv)
    return jnp.transpose(o, (0, 2, 1, 3))


def hybrid_mixer(h, cos, sin, w_in, conv_w, a_log, dt_bias, gdn_norm_w,
                 lam_q1, lam_k1, lam_q2, lam_k2, diff_norm_w, w_out, lam_init):
    b_, s_, _ = h.shape
    proj = h @ w_in
    gq, gk, gv, gz, gb, ga, dq, dk, dv = jnp.split(proj, IN_OFFSETS, axis=-1)
    qkv = jax.nn.silu(causal_depthwise_conv(jnp.concatenate([gq, gk, gv], -1), conv_w))
    gq, gk, gv = jnp.split(qkv, [GDN_QK_W, 2 * GDN_QK_W], axis=-1)
    beta = jax.nn.sigmoid(gb.astype(F32))
    log_decay = -jnp.exp(a_log.astype(F32)) * jax.nn.softplus(ga.astype(F32) + dt_bias.astype(F32))
    o_gdn = gated_delta_rule_chunked(gq.reshape(b_, s_, GDN_HEADS, GDN_DK),
                                     gk.reshape(b_, s_, GDN_HEADS, GDN_DK),
                                     gv.reshape(b_, s_, GDN_HEADS, GDN_DV), log_decay, beta)
    o_gdn = rms_norm(o_gdn, gdn_norm_w) * jax.nn.silu(gz.reshape(b_, s_, GDN_HEADS, GDN_DV).astype(F32))
    o_gdn = o_gdn.reshape(b_, s_, GDN_V_W).astype(h.dtype)
    dq = partial_rotary(dq.reshape(b_, s_, 2 * DIFF_HEADS, DIFF_D), cos, sin).reshape(b_, s_, DIFF_HEADS, 2, DIFF_D)
    dk = partial_rotary(dk.reshape(b_, s_, 2 * DIFF_HEADS, DIFF_D), cos, sin).reshape(b_, s_, DIFF_HEADS, 2, DIFF_D)
    lam = (jnp.exp(jnp.sum(lam_q1.astype(F32) * lam_k1.astype(F32)))
           - jnp.exp(jnp.sum(lam_q2.astype(F32) * lam_k2.astype(F32))) + lam_init)
    o_diff = diff_attention(dq, dk, dv.reshape(b_, s_, DIFF_HEADS, DIFF_DV), lam)
    o_diff = (rms_norm(o_diff, diff_norm_w) * (1.0 - lam_init)).reshape(b_, s_, DIFF_V_W)
    return jnp.concatenate([o_gdn, o_diff.astype(h.dtype)], -1) @ w_out


def moe_ffn(x2d, router_w, router_b, w_gu, b_gu, w_down, b_down):
    n_tok = x2d.shape[0]
    nk = n_tok * TOP_K
    m_pad = nk + N_EXPERTS * MOE_BLOCK
    n_blocks = m_pad // MOE_BLOCK
    logits = (x2d @ router_w + router_b).astype(F32)
    top_vals, top_idx = lax.top_k(logits, TOP_K)
    gates = jax.nn.softmax(top_vals, axis=-1)
    flat_e = top_idx.reshape(-1)
    flat_tok = jnp.repeat(jnp.arange(n_tok, dtype=jnp.int32), TOP_K)
    flat_gate = gates.reshape(-1)
    order = jnp.argsort(flat_e)
    sorted_e = flat_e[order]
    counts = jnp.bincount(flat_e, length=N_EXPERTS)
    padded = ((counts + MOE_BLOCK - 1) // MOE_BLOCK) * MOE_BLOCK
    pad_end = jnp.cumsum(padded)
    pad_start = pad_end - padded
    grp_start = jnp.cumsum(counts) - counts
    rank = jnp.arange(nk) - grp_start[sorted_e]
    dest = pad_start[sorted_e] + rank
    slot_tok = jnp.zeros((m_pad,), jnp.int32).at[dest].set(flat_tok[order])
    slot_gate = jnp.zeros((m_pad,), F32).at[dest].set(flat_gate[order])
    block_start = jnp.arange(n_blocks) * MOE_BLOCK
    block_expert = jnp.clip(jnp.searchsorted(pad_end, block_start, side='right'), 0, N_EXPERTS - 1)
    xs = x2d[slot_tok].reshape(n_blocks, MOE_BLOCK, x2d.shape[-1])

    def expert_block(args):
        xb, e = args
        hgu = xb @ w_gu[e] + b_gu[e]
        gate = jnp.minimum(hgu[:, :D_FF], SWIGLU_LIMIT)
        up = jnp.clip(hgu[:, D_FF:], -SWIGLU_LIMIT, SWIGLU_LIMIT)
        act = (up + 1.0) * gate * jax.nn.sigmoid(SWIGLU_ALPHA * gate)
        return act @ w_down[e] + b_down[e]

    ys = lax.map(expert_block, (xs, block_expert)).reshape(m_pad, -1)
    contrib = (ys.astype(F32) * slot_gate[:, None]).astype(x2d.dtype)
    return jnp.zeros_like(x2d).at[slot_tok].add(contrib)


def setup_inputs(seed: int = 0) -> dict:
    key = jax.random.key(seed)
    ks = jax.random.split(key, 32)
    L = DEPTH
    nrm = lambda k, shape, s: jax.random.normal(k, shape, F32) * s
    x = jax.random.normal(ks[0], (BATCH, SEQ, D_MODEL), F32)
    p = jax.random.normal(ks[1], (DEPTH, BATCH, SEQ, PLE_DIM), F32)
    positions = (jax.random.randint(ks[2], (BATCH, 1), 0, 1024) + jnp.arange(SEQ)[None, :]).astype(jnp.int32)
    col_scale = np.ones((IN_W,), np.float32)
    col_scale[IN_OFFSETS[1]:IN_OFFSETS[2]] = DN_BETA
    col_scale[IN_OFFSETS[7]:] = DN_BETA
    w_in = nrm(ks[3], (L, D_MODEL, IN_W), D_MODEL ** -0.5) * jnp.asarray(col_scale)
    conv_w = nrm(ks[4], (L, CONV_WIDTH, CONV_CH), CONV_WIDTH ** -0.5)
    a_log = jnp.log(jax.random.uniform(ks[5], (L, GDN_HEADS), F32, 1.0, 16.0))
    dt = jnp.exp(jax.random.uniform(ks[6], (L, GDN_HEADS), F32, math.log(1e-3), math.log(1e-1)))
    dt_bias = dt + jnp.log(-jnp.expm1(-dt))
    gdn_norm_w = 1.0 + nrm(ks[7], (L, GDN_DV), 0.02)
    lam_q1 = nrm(ks[8], (L, DIFF_D), 0.1)
    lam_k1 = nrm(ks[9], (L, DIFF_D), 0.1)
    lam_q2 = nrm(ks[10], (L, DIFF_D), 0.1)
    lam_k2 = nrm(ks[11], (L, DIFF_D), 0.1)
    diff_norm_w = 1.0 + nrm(ks[12], (L, DIFF_DV), 0.02)
    w_out = nrm(ks[13], (L, MIX_W, D_MODEL), MIX_W ** -0.5 * DN_BETA)
    ln1_g = 1.0 + nrm(ks[14], (L, D_MODEL), 0.02)
    ln1_b = nrm(ks[15], (L, D_MODEL), 0.02)
    router_w = nrm(ks[16], (L, D_MODEL, N_EXPERTS), D_MODEL ** -0.5)
    router_b = nrm(ks[17], (L, N_EXPERTS), 0.01)
    w_gu = nrm(ks[18], (L, N_EXPERTS, D_MODEL, 2 * D_FF), D_MODEL ** -0.5)
    b_gu = nrm(ks[19], (L, N_EXPERTS, 2 * D_FF), 0.01)
    w_down = nrm(ks[20], (L, N_EXPERTS, D_FF, D_MODEL), D_FF ** -0.5 * DN_BETA)
    b_down = nrm(ks[21], (L, N_EXPERTS, D_MODEL), 0.01)
    ln2_g = 1.0 + nrm(ks[22], (L, D_MODEL), 0.02)
    ln2_b = nrm(ks[23], (L, D_MODEL), 0.02)
    ple_w = nrm(ks[24], (L, PLE_DIM, D_MODEL), PLE_DIM ** -0.5 * DN_BETA)
    ple_gate_w = nrm(ks[25], (L, D_MODEL, D_MODEL), D_MODEL ** -0.5)
    ple_gate_b = nrm(ks[26], (L, D_MODEL), 0.01)
    ln3_g = 1.0 + nrm(ks[27], (L, D_MODEL), 0.02)
    ln3_b = nrm(ks[28], (L, D_MODEL), 0.02)
    return {'x': x, 'p': p, 'positions': positions, 'w_in': w_in, 'conv_w': conv_w,
            'a_log': a_log, 'dt_bias': dt_bias, 'gdn_norm_w': gdn_norm_w,
            'lam_q1': lam_q1, 'lam_k1': lam_k1, 'lam_q2': lam_q2, 'lam_k2': lam_k2,
            'diff_norm_w': diff_norm_w, 'w_out': w_out, 'ln1_g': ln1_g, 'ln1_b': ln1_b,
            'router_w': router_w, 'router_b': router_b, 'w_gu': w_gu, 'b_gu': b_gu,
            'w_down': w_down, 'b_down': b_down, 'ln2_g': ln2_g, 'ln2_b': ln2_b,
            'ple_w': ple_w, 'ple_gate_w': ple_gate_w, 'ple_gate_b': ple_gate_b,
            'ln3_g': ln3_g, 'ln3_b': ln3_b}


def reference(x, p, positions, w_in, conv_w, a_log, dt_bias, gdn_norm_w,
              lam_q1, lam_k1, lam_q2, lam_k2, diff_norm_w, w_out, ln1_g, ln1_b,
              router_w, router_b, w_gu, b_gu, w_down, b_down, ln2_g, ln2_b,
              ple_w, ple_gate_w, ple_gate_b, ln3_g, ln3_b):
    b_, s_, d_ = x.shape
    inv_freq = ROPE_THETA ** (-jnp.arange(0, ROPE_DIM, 2, dtype=F32) / ROPE_DIM)
    ang = positions.astype(F32)[..., None] * inv_freq
    ang = jnp.concatenate([ang, ang], -1)[:, :, None, :]
    cos = jnp.cos(ang).astype(x.dtype)
    sin = jnp.sin(ang).astype(x.dtype)
    h = x
    for i in range(DEPTH):
        lam_init = 0.8 - 0.6 * math.exp(-0.3 * i)
        mix = hybrid_mixer(h, cos, sin, w_in[i], conv_w[i], a_log[i], dt_bias[i], gdn_norm_w[i],
                           lam_q1[i], lam_k1[i], lam_q2[i], lam_k2[i], diff_norm_w[i], w_out[i], lam_init)
        h = layer_norm(DN_ALPHA * h + mix, ln1_g[i], ln1_b[i])
        ffn = moe_ffn(h.reshape(b_ * s_, d_), router_w[i], router_b[i], w_gu[i], b_gu[i],
                      w_down[i], b_down[i]).reshape(b_, s_, d_)
        h = layer_norm(DN_ALPHA * h + ffn, ln2_g[i], ln2_b[i])
        gate = jax.nn.sigmoid(h @ ple_gate_w[i] + ple_gate_b[i])
        ple = gate * (p[i].astype(h.dtype) @ ple_w[i])
        h = layer_norm(DN_ALPHA * h + ple, ln3_g[i], ln3_b[i])
    return h
```

```cpp
#include <hip/hip_runtime.h>
#include <stdint.h>
#include <cstdio>

#define LAS __attribute__((address_space(3)))
typedef float f32x4 __attribute__((ext_vector_type(4)));
typedef float f32x2 __attribute__((ext_vector_type(2)));

constexpr int NTOK = 16384, DM = 1024, SEQ = 4096, NBATCH = 4;
constexpr int INW = 3592;
constexpr int O_GQ = 0, O_GK = 512, O_GV = 1024, O_GZ = 1536, O_GB = 2048, O_GA = 2052, O_DQ = 2056, O_DK = 2568, O_DV = 3080;
constexpr int NE = 32, TOPK = 4, DFF = 1024;
constexpr int PADM = 256;
constexpr int MPAD = NTOK * TOPK + NE * PADM;
constexpr int NTILE_MAX = MPAD / PADM;
constexpr int PLE = 256;
constexpr float DN_ALPHA = 1.189207115002721f;
constexpr float LN_EPS = 1e-5f, RMS_EPS = 1e-6f;
constexpr float LAM_INIT = 0.2f;
constexpr int NT = 512, NWAVE = 8;
constexpr int NCHUNK = NTOK / 64;

constexpr size_t MB = 1u << 20;
constexpr size_t WS_CTL   = 0;
constexpr size_t WS_SMALL = 1 * MB;
constexpr size_t SM_BETA  = WS_SMALL;
constexpr size_t SM_LDEC  = SM_BETA + (size_t)NTOK * 16;
constexpr size_t SM_TOPI  = SM_LDEC + (size_t)NTOK * 16;
constexpr size_t SM_TOPG  = SM_TOPI + (size_t)NTOK * 16;
constexpr size_t SM_POS   = SM_TOPG + (size_t)NTOK * 16;
constexpr size_t SM_CNT   = SM_POS + (size_t)NTOK * 16;
constexpr size_t SM_BASE  = SM_CNT + (size_t)NCHUNK * 128;
constexpr size_t SM_SLOT  = SM_BASE + (size_t)NCHUNK * 128;
constexpr size_t SM_TEXP  = SM_SLOT + (size_t)MPAD * 4;
constexpr size_t SM_END   = SM_TEXP + 4096;
static_assert(SM_END <= 9 * MB, "small region");
constexpr size_t WS_PROJ  = 16 * MB;
constexpr size_t WS_QKV   = WS_PROJ + 236 * MB;
constexpr size_t WS_DQK   = WS_QKV + 101 * MB;
constexpr size_t WS_A_END = WS_DQK + 64 * MB;
constexpr size_t WS_ACT   = WS_PROJ;
static_assert(WS_ACT + (size_t)MPAD * 1024 * 4 <= WS_A_END, "act overlay");
constexpr size_t WS_OMIX  = WS_A_END;
constexpr size_t WS_CAT   = WS_OMIX + 64 * MB;
constexpr size_t WS_T     = WS_CAT + 64 * MB;
constexpr size_t WS_YS    = WS_A_END;
constexpr size_t WS_B_END = WS_A_END + 288 * MB;
static_assert(WS_YS + (size_t)MPAD * 1024 * 4 <= WS_B_END, "ys overlay");
constexpr size_t WS_T2    = WS_A_END;
constexpr size_t WS_H1    = WS_B_END;
constexpr size_t WS_H2    = WS_H1 + 64 * MB;
constexpr size_t WS_PP    = WS_H2 + 64 * MB;
constexpr size_t WS_END   = WS_PP + 64 * MB;
static_assert(WS_END <= 1024 * MB, "workspace");

struct Params {
    const float *x, *p; const int* positions;
    const float *w_in, *conv_w, *a_log, *dt_bias, *gdn_norm_w, *lam_q1, *lam_k1, *lam_q2, *lam_k2, *diff_norm_w, *w_out, *ln1_g, *ln1_b;
    const float *router_w, *router_b, *w_gu, *b_gu, *w_down, *b_down, *ln2_g, *ln2_b, *ple_w, *ple_gate_w, *ple_gate_b, *ln3_g, *ln3_b;
    float* out; unsigned char* ws;
    int stage_lo, stage_hi;
};

__device__ __forceinline__ float wave_sum(float v) {
#pragma unroll
    for (int o = 1; o < 64; o <<= 1) v += __shfl_xor(v, o);
    return v;
}
__device__ __forceinline__ float wave_max(float v) {
#pragma unroll
    for (int o = 1; o < 64; o <<= 1) v = fmaxf(v, __shfl_xor(v, o));
    return v;
}
__device__ __forceinline__ int wave_min_i(int v) {
#pragma unroll
    for (int o = 1; o < 64; o <<= 1) v = min(v, __shfl_xor(v, o));
    return v;
}
__device__ __forceinline__ float sigmoidf_(float x) { return 1.f / (1.f + __expf(-x)); }
__device__ __forceinline__ float siluf_(float x) { return x / (1.f + __expf(-x)); }
#define LDS_FENCE() asm volatile("s_waitcnt lgkmcnt(0)" ::: "memory")
__device__ const double INV_FREQ[8] = {1.0, 0.19392274474868576, 0.03760603093086393, 0.007292664737217109, 0.001414213562373095, 0.0002742481756762073, 5.318295896944988e-05, 1.031338537721246e-05};

struct GemmF32 {
    const float* A; int lda; const int* rowidx;
    const float* B; int ldb; size_t strideB; const int* tile_expert;
    int M, N, K; int dual;
};
template <class Epi>
__device__ __forceinline__ void gemm_f32(const GemmF32 g, const Epi& epi, int vb, int nvb, LAS float* lds) {
    LAS float* As = lds;
    LAS float* Bs = lds + 16 * 132;
    const int t = threadIdx.x, tx = t & 31, ty = t >> 5;
    const int tiles_m = g.M / 128, tiles_n = g.dual ? (1024 / 64) : ((g.N + 127) / 128);
    const int ntile = tiles_m * tiles_n;
    for (int tile = vb; tile < ntile; tile += nvb) {
        const int tm = tile / tiles_n, tn = tile % tiles_n;
        const int m0 = tm * 128;
        const int cb0 = g.dual ? tn * 64 : tn * 128, cb1 = g.dual ? 1024 + tn * 64 : tn * 128 + 64;
        const int e = g.tile_expert ? g.tile_expert[m0 / PADM] : 0;
        const float* Bp = g.B + (size_t)e * g.strideB;
        const int ar = t >> 2, akq = (t & 3) * 4;
        const int arow = g.rowidx ? g.rowidx[m0 + ar] : (m0 + ar);
        const float* Ap = g.A + (size_t)arow * g.lda + akq;
        const int bk = t >> 5, bc4 = (t & 31) * 4;
        const int bcol = (bc4 < 64) ? (cb0 + bc4) : (cb1 + bc4 - 64);
        const bool bok = bcol < g.N;
        const float* Bq = Bp + (size_t)bk * g.ldb + bcol;
        float acc[8][4];
#pragma unroll
        for (int i = 0; i < 8; ++i)
#pragma unroll
            for (int j = 0; j < 4; ++j) acc[i][j] = 0.f;
        for (int k0 = 0; k0 < g.K; k0 += 16) {
            const f32x4 av = *(const f32x4*)(Ap + k0);
            f32x4 bv = {0.f, 0.f, 0.f, 0.f};
            if (bok) bv = *(const f32x4*)(Bq + (size_t)k0 * g.ldb);
            __syncthreads();
            As[(akq + 0) * 132 + ar] = av.x; As[(akq + 1) * 132 + ar] = av.y; As[(akq + 2) * 132 + ar] = av.z; As[(akq + 3) * 132 + ar] = av.w;
            *(LAS f32x4*)(Bs + bk * 132 + bc4) = bv;
            __syncthreads();
#pragma unroll
            for (int k = 0; k < 16; ++k) {
                const f32x4 a0 = *(const LAS f32x4*)(As + k * 132 + ty * 8);
                const f32x4 a1 = *(const LAS f32x4*)(As + k * 132 + ty * 8 + 4);
                const f32x2 b0 = *(const LAS f32x2*)(Bs + k * 132 + tx * 2);
                const f32x2 b1 = *(const LAS f32x2*)(Bs + k * 132 + 64 + tx * 2);
                const float a[8] = {a0.x, a0.y, a0.z, a0.w, a1.x, a1.y, a1.z, a1.w};
#pragma unroll
                for (int i = 0; i < 8; ++i) { acc[i][0] += a[i] * b0.x; acc[i][1] += a[i] * b0.y; acc[i][2] += a[i] * b1.x; acc[i][3] += a[i] * b1.y; }
            }
        }
        const int clo = cb0 + tx * 2, chi = cb1 + tx * 2;
#pragma unroll
        for (int i = 0; i < 8; ++i) epi(m0 + ty * 8 + i, clo, acc[i][0], acc[i][1], chi, acc[i][2], acc[i][3], e);
    }
}

__device__ __forceinline__ void ln_rows(const float* in, const float* gam, const float* bet, float* out, int gw, int ngw, int lane) {
    for (int m = gw; m < NTOK; m += ngw) {
        const f32x4* xr = (const f32x4*)(in + (size_t)m * DM) + lane;
        f32x4 v[4]; float s = 0.f;
#pragma unroll
        for (int j = 0; j < 4; ++j) { v[j] = xr[64 * j]; s += (v[j].x + v[j].y) + (v[j].z + v[j].w); }
        const float mean = wave_sum(s) * (1.f / DM); float s2 = 0.f;
#pragma unroll
        for (int j = 0; j < 4; ++j) { v[j] = v[j] - mean; s2 += (v[j].x * v[j].x + v[j].y * v[j].y) + (v[j].z * v[j].z + v[j].w * v[j].w); }
        const float rstd = 1.f / sqrtf(wave_sum(s2) * (1.f / DM) + LN_EPS);
        f32x4* o = (f32x4*)(out + (size_t)m * DM) + lane;
#pragma unroll
        for (int j = 0; j < 4; ++j) { const f32x4 gg = ((const f32x4*)gam)[lane + 64 * j], bb = ((const f32x4*)bet)[lane + 64 * j]; o[64 * j] = v[j] * rstd * gg + bb; }
    }
}

#ifndef ONLY_STAGE
#define ONLY_STAGE -1
#endif
enum { ST_PROJ = 0, ST_PREP, ST_GDN, ST_ATT, ST_MIX, ST_OUTP, ST_LN1, ST_ROUTE, ST_SCAN, ST_SCATTER, ST_GU, ST_DOWN, ST_COMB, ST_PLEW, ST_PLEG, ST_LN3, ST_COUNT };

template <int ST> __device__ __forceinline__ void run_stage(const Params& P, unsigned char* lds_raw, int vb, int nvb) {
    LAS float* lds = (LAS float*)lds_raw;
    const int tid = threadIdx.x, lane = tid & 63, wave = tid >> 6;
    const int gw = vb * NWAVE + wave, ngw = nvb * NWAVE;
    unsigned char* ws = P.ws;
    float* proj = (float*)(ws + WS_PROJ);
    float* qkv = (float*)(ws + WS_QKV);
    float* dqk = (float*)(ws + WS_DQK);
    float* omix = (float*)(ws + WS_OMIX);
    float* cat = (float*)(ws + WS_CAT);
    float* T = (float*)(ws + WS_T);
    float* T2 = (float*)(ws + WS_T2);
    float* act = (float*)(ws + WS_ACT);
    float* ys = (float*)(ws + WS_YS);
    float* h1 = (float*)(ws + WS_H1);
    float* h2 = (float*)(ws + WS_H2);
    float* pp = (float*)(ws + WS_PP);
    float* betab = (float*)(ws + SM_BETA);
    float* ldec = (float*)(ws + SM_LDEC);
    int* topi = (int*)(ws + SM_TOPI);
    float* topg = (float*)(ws + SM_TOPG);
    int* posb = (int*)(ws + SM_POS);
    int* cntb = (int*)(ws + SM_CNT);
    int* baseb = (int*)(ws + SM_BASE);
    int* slot_tok = (int*)(ws + SM_SLOT);
    int* texp = (int*)(ws + SM_TEXP);

        if constexpr (ST == ST_PROJ) {
            GemmF32 g{P.x, DM, nullptr, P.w_in, INW, 0, nullptr, NTOK, INW, DM, 0};
            auto epi = [&](int row, int clo, float v0, float v1, int chi, float v2, float v3, int) {
                if (clo < INW) *(f32x2*)(proj + (size_t)row * INW + clo) = (f32x2){v0, v1};
                if (chi < INW) *(f32x2*)(proj + (size_t)row * INW + chi) = (f32x2){v2, v3};
            };
            gemm_f32(g, epi, vb, nvb, lds);
        }
        if constexpr (ST == ST_PREP) {
            for (int item = gw; item < NTOK * 12; item += ngw) {
                const int tok = item / 12, hs = item % 12, s = tok % SEQ;
                const int c0 = hs * 128 + lane * 2;
                float a0 = 0.f, a1 = 0.f;
#pragma unroll
                for (int w = 0; w < 4; ++w) { const int ss = s - 3 + w; if (ss >= 0) { const f32x2 xv = *(const f32x2*)(proj + (size_t)(tok - 3 + w) * INW + c0); const f32x2 cw = *(const f32x2*)(P.conv_w + w * 1536 + c0); a0 += xv.x * cw.x; a1 += xv.y * cw.y; } }
                a0 = siluf_(a0); a1 = siluf_(a1);
                if (hs < 8) { const float ss = wave_sum(a0 * a0 + a1 * a1); float r = 1.f / sqrtf(ss + 1e-6f); if (hs < 4) r *= 0.08838834764831845f; a0 *= r; a1 *= r; }
                *(f32x2*)(qkv + (size_t)tok * 1536 + c0) = (f32x2){a0, a1};
            }
            for (int i = vb * NT + tid; i < NTOK * 4; i += nvb * NT) {
                const int tok = i >> 2, h = i & 3;
                const float gb = proj[(size_t)tok * INW + O_GB + h], ga = proj[(size_t)tok * INW + O_GA + h];
                betab[i] = sigmoidf_(gb);
                const float z = ga + P.dt_bias[h]; const float sp = (z > 20.f) ? z : log1pf(expf(z));
                ldec[i] = -expf(P.a_log[h]) * sp;
            }
            for (int i = vb * NT + tid; i < NTOK * 16; i += nvb * NT) {
                const int tok = i >> 4, vec = i & 15;
                const float* src = proj + (size_t)tok * INW + (vec < 8 ? O_DQ + vec * 64 : O_DK + (vec - 8) * 64);
                float* dst = dqk + (size_t)tok * 1024 + vec * 64;
                const double pos = (double)P.positions[tok];
                float xr[16];
#pragma unroll
                for (int j = 0; j < 16; ++j) xr[j] = src[j];
#pragma unroll
                for (int j = 0; j < 8; ++j) {
                    const double rev = pos * (INV_FREQ[j] * 0.15915494309189535); const float fr = (float)(rev - floor(rev));
                    const float c = __builtin_amdgcn_cosf(fr), sn = __builtin_amdgcn_sinf(fr);
                    dst[j] = xr[j] * c - xr[j + 8] * sn; dst[j + 8] = xr[j + 8] * c + xr[j] * sn;
                }
                for (int j = 16; j < 64; ++j) dst[j] = src[j];
            }
        }
        if constexpr (ST == ST_GDN) {
            LAS float* kk = lds; LAS float* qq = lds + 2048; LAS float* vv = lds + 4096; LAS float* red = lds + 6144; LAS float* red2 = lds + 6144 + 512; LAS float* eb = lds + 6144 + 1024;
            for (int bh = vb; bh < 16; bh += nvb) {
                const int b = bh >> 2, h = bh & 3; const int v = tid & 127, kq = tid >> 7;
                float S[32];
#pragma unroll
                for (int j = 0; j < 32; ++j) S[j] = 0.f;
                for (int c = 0; c < SEQ / 16; ++c) {
                    const int tok0 = b * SEQ + c * 16;
                    __syncthreads();
                    { const int r = tid >> 5, c4 = (tid & 31) * 4; const float* base = qkv + (size_t)(tok0 + r) * 1536 + h * 128 + c4;
                      *(LAS f32x4*)(qq + r * 128 + c4) = *(const f32x4*)(base); *(LAS f32x4*)(kk + r * 128 + c4) = *(const f32x4*)(base + 512); *(LAS f32x4*)(vv + r * 128 + c4) = *(const f32x4*)(base + 1024);
                      if (tid < 16) { eb[tid] = expf(ldec[(size_t)(tok0 + tid) * 4 + h]); eb[16 + tid] = betab[(size_t)(tok0 + tid) * 4 + h]; } }
                    __syncthreads();
                    for (int i = 0; i < 16; ++i) {
                        float part = 0.f;
#pragma unroll
                        for (int j = 0; j < 32; ++j) part += S[j] * kk[i * 128 + kq * 32 + j];
                        red[kq * 128 + v] = part;
                        __syncthreads();
                        const float dotk = (red[v] + red[128 + v]) + (red[256 + v] + red[384 + v]);
                        const float ea = eb[i], be = eb[16 + i];
                        const float vnew = be * (vv[i * 128 + v] - ea * dotk);
                        float po = 0.f;
#pragma unroll
                        for (int j = 0; j < 32; ++j) { S[j] = ea * S[j] + kk[i * 128 + kq * 32 + j] * vnew; po += S[j] * qq[i * 128 + kq * 32 + j]; }
                        red2[kq * 128 + v] = po;
                        __syncthreads();
                        if (kq == 0) omix[(size_t)(tok0 + i) * 1024 + h * 128 + v] = (red2[v] + red2[128 + v]) + (red2[256 + v] + red2[384 + v]);
                    }
                }
            }
        }
        if constexpr (ST == ST_ATT) {
            LAS float* qs = lds + wave * 128;
            LAS float* sc = lds + 1024 + wave * 1024;
            const float lam = expf(wave_sum((lane < 64) ? P.lam_q1[lane] * P.lam_k1[lane] : 0.f)) - expf(wave_sum(P.lam_q2[lane] * P.lam_k2[lane])) + LAM_INIT;
            for (int item = gw; item < NTOK * 4; item += ngw) {
                const int h = item & 3, tokq = item >> 2; const int b = tokq / SEQ, q = tokq % SEQ; const int base = b * SEQ;
                LDS_FENCE();
                { const f32x2 qv = *(const f32x2*)(dqk + (size_t)tokq * 1024 + h * 128 + lane * 2); qs[lane * 2] = qv.x * 0.125f; qs[lane * 2 + 1] = qv.y * 0.125f; }
                LDS_FENCE();
                float m0 = -INFINITY, m1 = -INFINITY, l0 = 0.f, l1 = 0.f; f32x2 acc0 = {0.f, 0.f}, acc1 = {0.f, 0.f};
                for (int kc = 0; kc <= q; kc += 512) {
                    const int nk = min(512, q + 1 - kc);
                    float cm0 = -INFINITY, cm1 = -INFINITY;
#pragma unroll 1
                    for (int jj = 0; jj < 8; ++jj) {
                        const int key = kc + jj * 64 + lane;
                        float d0 = 0.f, d1 = 0.f;
                        if (key <= q) {
                            const f32x4* kp = (const f32x4*)(dqk + (size_t)(base + key) * 1024 + 512 + h * 128);
#pragma unroll 4
                            for (int d = 0; d < 16; ++d) { const f32x4 kv = kp[d]; const f32x4 q4 = *(const LAS f32x4*)(qs + d * 4); d0 += kv.x * q4.x + kv.y * q4.y + kv.z * q4.z + kv.w * q4.w; }
#pragma unroll 4
                            for (int d = 0; d < 16; ++d) { const f32x4 kv = kp[16 + d]; const f32x4 q4 = *(const LAS f32x4*)(qs + 64 + d * 4); d1 += kv.x * q4.x + kv.y * q4.y + kv.z * q4.z + kv.w * q4.w; }
                        } else { d0 = -INFINITY; d1 = -INFINITY; }
                        sc[jj * 64 + lane] = d0; sc[512 + jj * 64 + lane] = d1; cm0 = fmaxf(cm0, d0); cm1 = fmaxf(cm1, d1);
                    }
                    cm0 = wave_max(cm0); cm1 = wave_max(cm1);
                    const float mn0 = fmaxf(m0, cm0), mn1 = fmaxf(m1, cm1);
                    const float f0 = __expf(m0 - mn0), f1 = __expf(m1 - mn1);
                    acc0 = acc0 * f0; acc1 = acc1 * f1; l0 *= f0; l1 *= f1; m0 = mn0; m1 = mn1;
                    float ps0 = 0.f, ps1 = 0.f;
#pragma unroll 1
                    for (int jj = 0; jj < 8; ++jj) { const float p0 = __expf(sc[jj * 64 + lane] - mn0), p1 = __expf(sc[512 + jj * 64 + lane] - mn1); ps0 += p0; ps1 += p1; sc[jj * 64 + lane] = p0; sc[512 + jj * 64 + lane] = p1; }
                    l0 += wave_sum(ps0); l1 += wave_sum(ps1);
                    LDS_FENCE();
                    const float* vp = proj + (size_t)(base + kc) * INW + O_DV + h * 128 + lane * 2;
                    for (int k = 0; k < nk; ++k) { const float p0 = sc[k], p1 = sc[512 + k]; const f32x2 v2 = *(const f32x2*)(vp + (size_t)k * INW); acc0 += v2 * p0; acc1 += v2 * p1; }
                    LDS_FENCE();
                }
                const f32x2 o = acc0 * (1.f / l0) - acc1 * (lam / l1);
                *(f32x2*)(omix + (size_t)tokq * 1024 + 512 + h * 128 + lane * 2) = o;
            }
        }
        if constexpr (ST == ST_MIX) {
            for (int item = gw; item < NTOK * 8; item += ngw) {
                const int tok = item >> 3, hs = item & 7; const int c = hs * 128 + lane * 2;
                const f32x2 o = *(const f32x2*)(omix + (size_t)tok * 1024 + c);
                const float r = 1.f / sqrtf(wave_sum(o.x * o.x + o.y * o.y) * (1.f / 128.f) + RMS_EPS);
                f32x2 y;
                if (hs < 4) { const f32x2 w = *(const f32x2*)(P.gdn_norm_w + lane * 2); const f32x2 z = *(const f32x2*)(proj + (size_t)tok * INW + O_GZ + c); y.x = o.x * r * w.x * siluf_(z.x); y.y = o.y * r * w.y * siluf_(z.y); }
                else { const f32x2 w = *(const f32x2*)(P.diff_norm_w + lane * 2); y.x = o.x * r * w.x * (1.f - LAM_INIT); y.y = o.y * r * w.y * (1.f - LAM_INIT); }
                *(f32x2*)(cat + (size_t)tok * 1024 + c) = y;
            }
        }
        if constexpr (ST == ST_OUTP) {
            GemmF32 g{cat, DM, nullptr, P.w_out, DM, 0, nullptr, NTOK, DM, DM, 0};
            const float* x = P.x;
            auto epi = [&](int row, int clo, float v0, float v1, int chi, float v2, float v3, int) {
                const f32x2 xa = *(const f32x2*)(x + (size_t)row * DM + clo), xb = *(const f32x2*)(x + (size_t)row * DM + chi);
                *(f32x2*)(T + (size_t)row * DM + clo) = (f32x2){DN_ALPHA * xa.x + v0, DN_ALPHA * xa.y + v1};
                *(f32x2*)(T + (size_t)row * DM + chi) = (f32x2){DN_ALPHA * xb.x + v2, DN_ALPHA * xb.y + v3};
            };
            gemm_f32(g, epi, vb, nvb, lds);
        }
        if constexpr (ST == ST_LN1) ln_rows(T, P.ln1_g, P.ln1_b, h1, gw, ngw, lane);
        if constexpr (ST == ST_ROUTE) {
            int* hist = (int*)lds_raw;
            for (int c = vb; c < NCHUNK; c += nvb) {
                __syncthreads();
                if (tid < 32) hist[tid] = 0;
                __syncthreads();
                for (int i = 0; i < 8; ++i) {
                    const int tok = c * 64 + wave * 8 + i; const int e = lane & 31, half = lane >> 5;
                    const float* hr = h1 + (size_t)tok * DM + half * 512; const float* rw = P.router_w + (size_t)half * 512 * NE + e;
                    float a = 0.f;
                    for (int k = 0; k < 512; ++k) a += hr[k] * rw[(size_t)k * NE];
                    a += __shfl_xor(a, 32);
                    float v = a + P.router_b[e];
                    float tv[4]; int ti[4];
#pragma unroll
                    for (int r = 0; r < 4; ++r) { const float m = wave_max(v); const int idx = wave_min_i((v == m) ? e : 64); tv[r] = m; ti[r] = idx; if (e == idx) v = -INFINITY; }
                    const float e1 = __expf(tv[1] - tv[0]), e2 = __expf(tv[2] - tv[0]), e3 = __expf(tv[3] - tv[0]); const float inv = 1.f / (1.f + e1 + e2 + e3);
                    if (lane == 0) { *(int4*)(topi + (size_t)tok * 4) = make_int4(ti[0], ti[1], ti[2], ti[3]); *(f32x4*)(topg + (size_t)tok * 4) = (f32x4){inv, e1 * inv, e2 * inv, e3 * inv};
                        atomicAdd(&hist[ti[0]], 1); atomicAdd(&hist[ti[1]], 1); atomicAdd(&hist[ti[2]], 1); atomicAdd(&hist[ti[3]], 1); }
                }
                __syncthreads();
                if (tid < 32) cntb[c * 32 + tid] = hist[tid];
            }
        }
        if constexpr (ST == ST_SCAN) {
            if (vb == 0) {
                int* cnt_e = (int*)lds_raw; int* start_e = cnt_e + 32;
                if (tid < 32) { int tot = 0; for (int c = 0; c < NCHUNK; ++c) { baseb[c * 32 + tid] = tot; tot += cntb[c * 32 + tid]; } cnt_e[tid] = tot; }
                __syncthreads();
                if (tid == 0) { int ps = 0; for (int e = 0; e < NE; ++e) { start_e[e] = ps; const int padded = (cnt_e[e] + PADM - 1) / PADM * PADM; for (int i = 0; i < padded / PADM; ++i) texp[ps / PADM + i] = e; ps += padded; } texp[NTILE_MAX] = ps / PADM; }
                __syncthreads();
                if (tid < 32) { const int s0 = start_e[tid]; for (int c = 0; c < NCHUNK; ++c) baseb[c * 32 + tid] += s0; }
                for (int e = 0; e < NE; ++e) { const int cn = cnt_e[e], padded = (cn + PADM - 1) / PADM * PADM; for (int r = cn + tid; r < padded; r += NT) slot_tok[start_e[e] + r] = 0; }
            }
        }
        if constexpr (ST == ST_SCATTER) {
            for (int c = vb; c < NCHUNK; c += nvb) {
                if (tid < 32) { int cur = baseb[c * 32 + tid]; for (int i = 0; i < 256; ++i) { const int tok = c * 64 + (i >> 2); if (topi[(size_t)tok * 4 + (i & 3)] == tid) { slot_tok[cur] = tok; posb[(size_t)tok * 4 + (i & 3)] = cur; ++cur; } } }
            }
        }
        if constexpr (ST == ST_GU) {
            const int ntl = texp[NTILE_MAX];
            GemmF32 g{h1, DM, slot_tok, P.w_gu, 2 * DFF, (size_t)DM * 2 * DFF, texp, ntl * PADM, 2 * DFF, DM, 1};
            const float* bgu = P.b_gu;
            auto epi = [&](int row, int clo, float v0, float v1, int chi, float v2, float v3, int e) {
                const float* bb = bgu + (size_t)e * 2 * DFF;
                const float g0 = fminf(v0 + bb[clo], 7.f), g1 = fminf(v1 + bb[clo + 1], 7.f);
                const float u0 = fminf(fmaxf(v2 + bb[chi], -7.f), 7.f), u1 = fminf(fmaxf(v3 + bb[chi + 1], -7.f), 7.f);
                *(f32x2*)(act + (size_t)row * DFF + clo) = (f32x2){(u0 + 1.f) * g0 * sigmoidf_(1.702f * g0), (u1 + 1.f) * g1 * sigmoidf_(1.702f * g1)};
            };
            gemm_f32(g, epi, vb, nvb, lds);
        }
        if constexpr (ST == ST_DOWN) {
            const int ntl = texp[NTILE_MAX];
            GemmF32 g{act, DFF, nullptr, P.w_down, DM, (size_t)DFF * DM, texp, ntl * PADM, DM, DFF, 0};
            const float* bd = P.b_down;
            auto epi = [&](int row, int clo, float v0, float v1, int chi, float v2, float v3, int e) {
                const float* bb = bd + (size_t)e * DM;
                *(f32x2*)(ys + (size_t)row * DM + clo) = (f32x2){v0 + bb[clo], v1 + bb[clo + 1]};
                *(f32x2*)(ys + (size_t)row * DM + chi) = (f32x2){v2 + bb[chi], v3 + bb[chi + 1]};
            };
            gemm_f32(g, epi, vb, nvb, lds);
        }
        if constexpr (ST == ST_COMB) {
            for (int m = gw; m < NTOK; m += ngw) {
                const int4 ps = *(const int4*)(posb + (size_t)m * 4); const f32x4 gt = *(const f32x4*)(topg + (size_t)m * 4);
                const f32x4* hr = (const f32x4*)(h1 + (size_t)m * DM) + lane;
                const f32x4* y0 = (const f32x4*)(ys + (size_t)ps.x * DM) + lane; const f32x4* y1 = (const f32x4*)(ys + (size_t)ps.y * DM) + lane;
                const f32x4* y2 = (const f32x4*)(ys + (size_t)ps.z * DM) + lane; const f32x4* y3 = (const f32x4*)(ys + (size_t)ps.w * DM) + lane;
                f32x4 v[4]; float s = 0.f;
#pragma unroll
                for (int j = 0; j < 4; ++j) { v[j] = hr[64 * j] * DN_ALPHA + ((y0[64 * j] * gt.x + y1[64 * j] * gt.y) + (y2[64 * j] * gt.z + y3[64 * j] * gt.w)); s += (v[j].x + v[j].y) + (v[j].z + v[j].w); }
                const float mean = wave_sum(s) * (1.f / DM); float s2 = 0.f;
#pragma unroll
                for (int j = 0; j < 4; ++j) { v[j] = v[j] - mean; s2 += (v[j].x * v[j].x + v[j].y * v[j].y) + (v[j].z * v[j].z + v[j].w * v[j].w); }
                const float rstd = 1.f / sqrtf(wave_sum(s2) * (1.f / DM) + LN_EPS);
                f32x4* o = (f32x4*)(h2 + (size_t)m * DM) + lane;
#pragma unroll
                for (int j = 0; j < 4; ++j) { const f32x4 gg = ((const f32x4*)P.ln2_g)[lane + 64 * j], bb = ((const f32x4*)P.ln2_b)[lane + 64 * j]; o[64 * j] = v[j] * rstd * gg + bb; }
            }
        }
        if constexpr (ST == ST_PLEW) {
            GemmF32 g{P.p, PLE, nullptr, P.ple_w, DM, 0, nullptr, NTOK, DM, PLE, 0};
            auto epi = [&](int row, int clo, float v0, float v1, int chi, float v2, float v3, int) {
                *(f32x2*)(pp + (size_t)row * DM + clo) = (f32x2){v0, v1}; *(f32x2*)(pp + (size_t)row * DM + chi) = (f32x2){v2, v3};
            };
            gemm_f32(g, epi, vb, nvb, lds);
        }
        if constexpr (ST == ST_PLEG) {
            GemmF32 g{h2, DM, nullptr, P.ple_gate_w, DM, 0, nullptr, NTOK, DM, DM, 0};
            const float* gbias = P.ple_gate_b;
            auto epi = [&](int row, int clo, float v0, float v1, int chi, float v2, float v3, int) {
                const f32x2 ha = *(const f32x2*)(h2 + (size_t)row * DM + clo), hb = *(const f32x2*)(h2 + (size_t)row * DM + chi);
                const f32x2 pa = *(const f32x2*)(pp + (size_t)row * DM + clo), pb = *(const f32x2*)(pp + (size_t)row * DM + chi);
                *(f32x2*)(T2 + (size_t)row * DM + clo) = (f32x2){DN_ALPHA * ha.x + sigmoidf_(v0 + gbias[clo]) * pa.x, DN_ALPHA * ha.y + sigmoidf_(v1 + gbias[clo + 1]) * pa.y};
                *(f32x2*)(T2 + (size_t)row * DM + chi) = (f32x2){DN_ALPHA * hb.x + sigmoidf_(v2 + gbias[chi]) * pb.x, DN_ALPHA * hb.y + sigmoidf_(v3 + gbias[chi + 1]) * pb.y};
            };
            gemm_f32(g, epi, vb, nvb, lds);
        }
        if constexpr (ST == ST_LN3) ln_rows(T2, P.ln3_g, P.ln3_b, P.out, gw, ngw, lane);
}

template <int ST> __global__ void __launch_bounds__(NT, 2) k_stage(Params P) {
    extern __shared__ __attribute__((aligned(16))) unsigned char lds_raw[];
    run_stage<ST>(P, lds_raw, blockIdx.x, gridDim.x);
}
constexpr int LDS_BYTES = 65536;
template <int ST> static void launch_stage(const Params& P, hipStream_t stream) {
    static bool attr_set = false;
    if (!attr_set) { (void)hipFuncSetAttribute((const void*)k_stage<ST>, hipFuncAttributeMaxDynamicSharedMemorySize, LDS_BYTES); attr_set = true; }
    hipLaunchKernelGGL(k_stage<ST>, dim3(512), dim3(NT), LDS_BYTES, stream, P);
}
template <int ST> static void launch_all(const Params& P, hipStream_t stream) {
    if constexpr (ST < ST_COUNT) { launch_stage<ST>(P, stream); launch_all<ST + 1>(P, stream); }
}

extern "C" void kernel_launch(void* const* d_in, const int* in_sizes, int n_in, void* d_out, int out_size, void* d_ws, size_t ws_size, hipStream_t stream) {
    if (n_in != 29 || ws_size < WS_END) { fprintf(stderr, "kernel_launch: unexpected inputs (n_in %d, ws %zu)\n", n_in, ws_size); return; }
    Params P{};
    P.x = (const float*)d_in[0]; P.p = (const float*)d_in[1]; P.positions = (const int*)d_in[2];
    P.w_in = (const float*)d_in[3]; P.conv_w = (const float*)d_in[4]; P.a_log = (const float*)d_in[5]; P.dt_bias = (const float*)d_in[6]; P.gdn_norm_w = (const float*)d_in[7];
    P.lam_q1 = (const float*)d_in[8]; P.lam_k1 = (const float*)d_in[9]; P.lam_q2 = (const float*)d_in[10]; P.lam_k2 = (const float*)d_in[11]; P.diff_norm_w = (const float*)d_in[12];
    P.w_out = (const float*)d_in[13]; P.ln1_g = (const float*)d_in[14]; P.ln1_b = (const float*)d_in[15]; P.router_w = (const float*)d_in[16]; P.router_b = (const float*)d_in[17];
    P.w_gu = (const float*)d_in[18]; P.b_gu = (const float*)d_in[19]; P.w_down = (const float*)d_in[20]; P.b_down = (const float*)d_in[21]; P.ln2_g = (const float*)d_in[22]; P.ln2_b = (const float*)d_in[23];
    P.ple_w = (const float*)d_in[24]; P.ple_gate_w = (const float*)d_in[25]; P.ple_gate_b = (const float*)d_in[26]; P.ln3_g = (const float*)d_in[27]; P.ln3_b = (const float*)d_in[28];
    P.out = (float*)d_out; P.ws = (unsigned char*)d_ws;
    launch_all<0>(P, stream);
}
```
